# Optimizing an MI355X kernel written in HIP

```python
import jax, jax.numpy as jnp
from jax import lax
import numpy as np

D_MODEL = 2048
BATCH = 4
SEQ = 4096
DEPTH = 1

HEAD_DIM = 128
DILATION_PAIRS = ((128, 1), (512, 4), (2048, 16))
N_GROUPS = len(DILATION_PAIRS)
HEADS_PER_GROUP = D_MODEL // (4 * HEAD_DIM)
N_ATTN_HEADS = N_GROUPS * HEADS_PER_GROUP
ATTN_WIDTH = N_ATTN_HEADS * HEAD_DIM
ATTN_OUT_WIDTH = HEADS_PER_GROUP * HEAD_DIM
ROT_DIM = HEAD_DIM // 4
ROPE_THETA = 500000.0
POOL_WINDOWS = (2, 4, 8, 16)
POOL_WIDTH = D_MODEL // 4
POOL_GROUP_WIDTH = POOL_WIDTH // len(POOL_WINDOWS)
IN_WIDTH = 3 * ATTN_WIDTH + POOL_WIDTH
D_FF = 3 * D_MODEL
CONV_WIDTH = 3
NORM_EPS = 1e-6
NEG_INF = -1e30

kernel_name = 'hybrid_dilated_attn_pool_convffn_encoder'


def rmsnorm(x, g):
    xf = x.astype(jnp.float32)
    y = xf * lax.rsqrt(jnp.mean(xf * xf, axis=-1, keepdims=True) + NORM_EPS)
    return (y * g.astype(jnp.float32)).astype(x.dtype)


def partial_rotary(x, pos):
    half = ROT_DIM // 2
    inv_freq = ROPE_THETA ** (-jnp.arange(0, ROT_DIM, 2, dtype=jnp.float32) / ROT_DIM)
    ang = pos.astype(jnp.float32)[:, None] * inv_freq[None, :]
    cos = jnp.cos(ang)[None, :, None, :]
    sin = jnp.sin(ang)[None, :, None, :]
    xf = x.astype(jnp.float32)
    x1, x2, rest = xf[..., :half], xf[..., half:ROT_DIM], xf[..., ROT_DIM:]
    out = jnp.concatenate([x1 * cos - x2 * sin, x2 * cos + x1 * sin, rest], axis=-1)
    return out.astype(x.dtype)


def banded_attention(q, k, v, radius):
    L, Dh = q.shape[-2], q.shape[-1]
    lead = q.shape[:-2]
    blk = radius
    nb = -(-L // blk)
    Lp = nb * blk
    npad = [(0, 0)] * len(lead)
    qb = jnp.pad(q, npad + [(0, Lp - L), (0, 0)]).reshape(*lead, nb, blk, Dh)
    kb = jnp.pad(k, npad + [(blk, Lp - L + blk), (0, 0)]).reshape(*lead, nb + 2, blk, Dh)
    vb = jnp.pad(v, npad + [(blk, Lp - L + blk), (0, 0)]).reshape(*lead, nb + 2, blk, Dh)

    def window(xb):
        return jnp.concatenate([xb[..., :-2, :, :], xb[..., 1:-1, :, :], xb[..., 2:, :, :]], axis=-2)

    kw, vw = window(kb), window(vb)
    s = jnp.einsum('...nqd,...nkd->...nqk', qb.astype(jnp.float32), kw.astype(jnp.float32)) * (Dh ** -0.5)
    qi = jnp.arange(nb)[:, None, None] * blk + jnp.arange(blk)[None, :, None]
    kj = jnp.arange(nb)[:, None, None] * blk - blk + jnp.arange(3 * blk)[None, None, :]
    valid = (jnp.abs(kj - qi) <= radius) & (kj >= 0) & (kj < L)
    s = jnp.where(valid, s, NEG_INF)
    m = jnp.max(s, axis=-1, keepdims=True)
    p = jnp.where(valid, jnp.exp(s - m), 0.0)
    den = jnp.sum(p, axis=-1, keepdims=True)
    o = jnp.einsum('...nqk,...nkd->...nqd', p, vw.astype(jnp.float32)) / den
    lse = (m + jnp.log(den))[..., 0]
    o = o.reshape(*lead, Lp, Dh)[..., :L, :]
    lse = lse.reshape(*lead, Lp)[..., :L]
    return o, lse


def dilated_attention(q, k, v, dilation, radius):
    B, H, S, Dh = q.shape
    L = S // dilation

    def split(t):
        return t.reshape(B, H, L, dilation, Dh).transpose(0, 1, 3, 2, 4)

    o, lse = banded_attention(split(q), split(k), split(v), radius)
    o = o.transpose(0, 1, 3, 2, 4).reshape(B, H, S, Dh)
    lse = lse.transpose(0, 1, 3, 2).reshape(B, H, S)
    return o, lse


def multiscale_pool(p):
    S = p.shape[1]
    pf = p.astype(jnp.float32)
    c = jnp.concatenate([jnp.zeros_like(pf[:, :1]), jnp.cumsum(pf, axis=1)], axis=1)
    t = jnp.arange(S)
    outs = []
    for g, w in enumerate(POOL_WINDOWS):
        sl = slice(g * POOL_GROUP_WIDTH, (g + 1) * POOL_GROUP_WIDTH)
        cg = c[..., sl]
        lo = jnp.maximum(t - w // 2, 0)
        hi = jnp.minimum(t + w // 2, S)
        cnt = (hi - lo).astype(jnp.float32)[None, :, None]
        mean = (jnp.take(cg, hi, axis=1) - jnp.take(cg, lo, axis=1)) / cnt
        outs.append(mean - pf[..., sl])
    return jnp.concatenate(outs, axis=-1).astype(p.dtype)


def depthwise_conv3(a, w, b):
    ap = jnp.pad(a, ((0, 0), (1, 1), (0, 0)))
    return ap[:, :-2] * w[0] + ap[:, 1:-1] * w[1] + ap[:, 2:] * w[2] + b


def setup_inputs(seed: int = 0) -> dict:
    key = jax.random.key(seed)
    ks = jax.random.split(key, 16)
    f32 = jnp.float32

    def dense(k, shape, fan_in):
        return jax.random.normal(k, shape, f32) * (fan_in ** -0.5)

    return {
        'x': jax.random.normal(ks[0], (BATCH, SEQ, D_MODEL), f32),
        'norm_mix_g': 1.0 + 0.02 * jax.random.normal(ks[1], (D_MODEL,), f32),
        'w_in': dense(ks[2], (D_MODEL, IN_WIDTH), D_MODEL),
        'w_attn_out': dense(ks[3], (ATTN_OUT_WIDTH, D_MODEL), ATTN_OUT_WIDTH),
        'pool_w': dense(ks[4], (len(POOL_WINDOWS), POOL_GROUP_WIDTH, POOL_GROUP_WIDTH), POOL_GROUP_WIDTH),
        'pool_scale': 1.0 + 0.02 * jax.random.normal(ks[5], (POOL_WIDTH,), f32),
        'w_pool_out': dense(ks[6], (POOL_WIDTH, D_MODEL), POOL_WIDTH),
        'w_gate': dense(ks[7], (D_MODEL, 2 * D_MODEL), D_MODEL),
        'w_out': dense(ks[8], (D_MODEL, D_MODEL), D_MODEL),
        'norm_ffn_g': 1.0 + 0.02 * jax.random.normal(ks[9], (D_MODEL,), f32),
        'w_up': dense(ks[10], (D_MODEL, 2 * D_FF), D_MODEL),
        'conv_w': dense(ks[11], (CONV_WIDTH, D_FF), CONV_WIDTH),
        'conv_b': 0.01 * jax.random.normal(ks[12], (D_FF,), f32),
        'w_down': dense(ks[13], (D_FF, D_MODEL), D_FF),
        'norm_final_g': 1.0 + 0.02 * jax.random.normal(ks[14], (D_MODEL,), f32),
    }


def reference(x, norm_mix_g, w_in, w_attn_out, pool_w, pool_scale, w_pool_out, w_gate, w_out,
              norm_ffn_g, w_up, conv_w, conv_b, w_down, norm_final_g):
    B, S, _ = x.shape
    pos = jnp.arange(S)
    h = x
    for _layer in range(DEPTH):
        u = rmsnorm(h, norm_mix_g)
        proj = u @ w_in
        q, k, v, p = jnp.split(proj, [ATTN_WIDTH, 2 * ATTN_WIDTH, 3 * ATTN_WIDTH], axis=-1)
        q = partial_rotary(q.reshape(B, S, N_ATTN_HEADS, HEAD_DIM), pos)
        k = partial_rotary(k.reshape(B, S, N_ATTN_HEADS, HEAD_DIM), pos)
        v = v.reshape(B, S, N_ATTN_HEADS, HEAD_DIM)

        outs, lses = [], []
        for g, (window, dil) in enumerate(DILATION_PAIRS):
            sl = slice(g * HEADS_PER_GROUP, (g + 1) * HEADS_PER_GROUP)
            qg = q[:, :, sl].transpose(0, 2, 1, 3)
            kg = k[:, :, sl].transpose(0, 2, 1, 3)
            vg = v[:, :, sl].transpose(0, 2, 1, 3)
            o, l = dilated_attention(qg, kg, vg, dil, window // 2 // dil)
            outs.append(o)
            lses.append(l)
        alpha = jax.nn.softmax(jnp.stack(lses, axis=0), axis=0)
        attn = jnp.sum(alpha[..., None] * jnp.stack(outs, axis=0), axis=0)
        attn = attn.transpose(0, 2, 1, 3).reshape(B, S, ATTN_OUT_WIDTH).astype(h.dtype)
        y_a = attn @ w_attn_out

        pooled = multiscale_pool(p).reshape(B, S, len(POOL_WINDOWS), POOL_GROUP_WIDTH)
        pm = jnp.einsum('bsgc,gcd->bsgd', pooled, pool_w).reshape(B, S, POOL_WIDTH) * pool_scale
        y_b = pm @ w_pool_out

        g_a, g_b = jnp.split(jax.nn.sigmoid(u @ w_gate), 2, axis=-1)
        h = h + (g_a * y_a + g_b * y_b) @ w_out

        z = rmsnorm(h, norm_ffn_g)
        a, b = jnp.split(z @ w_up, 2, axis=-1)
        a = depthwise_conv3(a, conv_w, conv_b)
        h = h + (jax.nn.gelu(a, approximate=False) * b) @ w_down
    return rmsnorm(h, norm_final_g)
```

```cpp
#include <hip/hip_runtime.h>
#include <hip/hip_cooperative_groups.h>
#include <cstdio>
#include <cstdint>
#include <cmath>
namespace cg = cooperative_groups;
namespace pg8 {
#define PG8_LAS __attribute__((address_space(3)))
typedef unsigned short bf16_t;
typedef short bf16x8 __attribute__((ext_vector_type(8)));
typedef float f32x4 __attribute__((ext_vector_type(4)));
typedef unsigned u32x4 __attribute__((ext_vector_type(4)));
constexpr int BM = 256, BK = 64, HALF = 128, HTB = HALF * BK * 2  , STAGE_BYTES = 8 * HTB, NXCD = 8, WGM = 8;

__host__ __device__ __forceinline__ int lds_byte(int r, int c) { const int st = (r >> 4) * 2 + (c >> 5), rr = r & 15, cc = c & 31, ob = rr * 64 + cc * 2; return st * 1024 + (ob ^ (((ob >> 9) & 1) << 5)); }
__host__ __device__ __forceinline__ void stage_rc(int b, int& R, int& C) { const int st = b / 1024, sb = b % 1024, swz = sb ^ (((sb >> 9) & 1) << 5); R = (st >> 1) * 16 + swz / 64; C = (st & 1) * 32 + (swz % 64) / 2; }
__host__ __device__ __forceinline__ int perm32(int rho) { const int n = rho >> 4, i = rho & 15; return 8 * (i >> 2) + 4 * n + (i & 3); }

struct Unit { int pm, pn; };
struct Gemm { const bf16_t* A; const bf16_t* Bt; int M, N, K; };

struct StaticOrder {
    int nM, nN, nwg, G, c;
    __host__ __device__ void init(int M, int N, int G_, int c_) { nM = M / BM; nN = N / BM; nwg = nM * nN; G = G_; c = c_; }
    __host__ __device__ bool next(int i, Unit& u) const {
        const long L = (long)i * G + c; if (L >= nwg) return false;
        int wgid = (int)L; { const int q = nwg / NXCD, r = nwg % NXCD, xcd = wgid % NXCD, off = wgid / NXCD; wgid = (xcd < r ? xcd * (q + 1) : r * (q + 1) + (xcd - r) * q) + off; }
        const int nig = WGM * nN, gid = wgid / nig, fm = gid * WGM, gsz = (nM - fm) < WGM ? (nM - fm) : WGM;
        u.pm = fm + ((wgid % nig) % gsz); u.pn = (wgid % nig) / gsz; return true;
    }
    __device__ __forceinline__ void a_ready(const Unit&) const {}
    __device__ __forceinline__ void done(const Unit&) const {}
};

__device__ __forceinline__ unsigned cvt_pk_bf16(float lo, float hi) { unsigned r; asm volatile("v_cvt_pk_bf16_f32 %0, %1, %2" : "=v"(r) : "v"(lo), "v"(hi)); return r; }
typedef float f32x2 __attribute__((ext_vector_type(2)));
__device__ __forceinline__ f32x2 gelu_pk(f32x2 v) {
    const f32x2 av = __builtin_elementwise_abs(v), d = av * 0.2316418882f + 1.0f;
    f32x2 t; t.x = __builtin_amdgcn_rcpf(d.x); t.y = __builtin_amdgcn_rcpf(d.y);
    f32x2 q = t * 0.5307027145f + (-0.7265760135f); q = q * t + 0.7107068705f; q = q * t + (-0.142248368f); q = q * t + 0.127414796f; q = q * t;
    const f32x2 s = (v * v) * (-0.72134752044f);
    f32x2 e; e.x = __builtin_amdgcn_exp2f(s.x); e.y = __builtin_amdgcn_exp2f(s.y);
    const f32x2 m = v * (q * e), r = v - m;
    f32x2 o; o.x = v.x < 0.f ? m.x : r.x; o.y = v.y < 0.f ? m.y : r.y; return o;
}
typedef unsigned u32x2 __attribute__((ext_vector_type(2)));
__device__ __forceinline__ float bf_lo(unsigned w) { return __uint_as_float(w << 16); }
__device__ __forceinline__ float bf_hi(unsigned w) { return __uint_as_float(w & 0xffff0000u); }
__device__ __forceinline__ f32x4 shfl4(f32x4 v, int src) { f32x4 r; r[0] = __shfl(v[0], src); r[1] = __shfl(v[1], src); r[2] = __shfl(v[2], src); r[3] = __shfl(v[3], src); return r; }
__device__ __forceinline__ f32x4 gelu4(f32x4 v) { f32x2 a = gelu_pk((f32x2){v[0], v[1]}), b = gelu_pk((f32x2){v[2], v[3]}); return (f32x4){a.x, a.y, b.x, b.y}; }
#define EPI_BAR() do { asm volatile("s_waitcnt lgkmcnt(0)" ::: "memory"); __builtin_amdgcn_s_barrier(); asm volatile("" ::: "memory"); } while (0)

struct EpiProj {
    static constexpr bool PERM = true, AFTER_DRAIN = false;
    bf16_t* QKV; bf16_t* P; bf16_t* G; const float* rope; float qscale;
    __device__ __forceinline__ void operator()(const f32x4 (&acc)[2][2][4][2], const Unit& u, int wr, int wc, int fr, int fq) const {
        const int pn = u.pn; bf16_t* base; int ldc, colt, mode;
        if (pn < 18) { base = QKV; ldc = 4608; colt = pn * 256; mode = pn < 6 ? 0 : (pn < 12 ? 1 : 2); }
        else if (pn < 20) { base = P; ldc = 512; colt = (pn - 18) * 256; mode = 2; }
        else { base = G; ldc = 4096; colt = (pn - 20) * 256; mode = 3; }
        const int row0 = u.pm * BM + wr * 64 + fr, col0 = colt + wc * 32 + 8 * fq;
        const bool rot = (mode <= 1) && (wc == 0);
        const float sgn = fq < 2 ? -1.f : 1.f; const int i0 = 8 * (fq & 1);
#pragma unroll
        for (int ai = 0; ai < 2; ++ai)
#pragma unroll
            for (int m = 0; m < 4; ++m) {
                const int row = row0 + ai * HALF + m * 16; bf16_t* rowp = base + (size_t)row * ldc + col0;
                f32x4 c0 = {1.f, 1.f, 1.f, 1.f}, c1 = c0, s0 = {0.f, 0.f, 0.f, 0.f}, s1 = s0;
                if (rot) { const float* rp = rope + (size_t)(row & 4095) * 32 + i0; c0 = *(const f32x4*)rp; c1 = *(const f32x4*)(rp + 4); s0 = *(const f32x4*)(rp + 16); s1 = *(const f32x4*)(rp + 20); s0 = s0 * sgn; s1 = s1 * sgn; }
#pragma unroll
                for (int bj = 0; bj < 2; ++bj) {
                    f32x4 v0 = acc[ai][bj][m][0], v1 = acc[ai][bj][m][1];
                    if (rot) { const int src = (fq * 16 + fr) ^ 32; const f32x4 p0 = shfl4(v0, src), p1 = shfl4(v1, src); v0 = v0 * c0 + p0 * s0; v1 = v1 * c1 + p1 * s1; }
                    if (mode == 0) { v0 = v0 * qscale; v1 = v1 * qscale; }
                    if (mode == 3) {
#pragma unroll
                        for (int j = 0; j < 4; ++j) { v0[j] = __builtin_amdgcn_rcpf(1.f + __builtin_amdgcn_exp2f(-1.4426950408889634f * v0[j])); v1[j] = __builtin_amdgcn_rcpf(1.f + __builtin_amdgcn_exp2f(-1.4426950408889634f * v1[j])); }
                    }
                    u32x4 w; w.x = cvt_pk_bf16(v0[0], v0[1]); w.y = cvt_pk_bf16(v0[2], v0[3]); w.z = cvt_pk_bf16(v1[0], v1[1]); w.w = cvt_pk_bf16(v1[2], v1[3]);
                    *(u32x4*)(rowp + bj * HALF) = w; }
            }
    }
};

struct EpiMix {
    static constexpr bool PERM = true, AFTER_DRAIN = false;
    const bf16_t* G; bf16_t* MIX;
    __device__ __forceinline__ void operator()(const f32x4 (&acc)[2][2][4][2], const Unit& u, int wr, int wc, int fr, int fq) const {
        const int row0 = u.pm * BM + wr * 64 + fr, c0 = u.pn * HALF + wc * 32 + 8 * fq;
#pragma unroll
        for (int ai = 0; ai < 2; ++ai)
#pragma unroll
            for (int m = 0; m < 4; ++m) {
                const size_t row = (size_t)(row0 + ai * HALF + m * 16);
                const u32x4 ga = *(const u32x4*)(G + row * 4096 + c0), gb = *(const u32x4*)(G + row * 4096 + 2048 + c0);
                const f32x4 ya0 = acc[ai][0][m][0], ya1 = acc[ai][0][m][1], yb0 = acc[ai][1][m][0], yb1 = acc[ai][1][m][1];
                u32x4 w;
                w.x = cvt_pk_bf16(bf_lo(ga.x) * ya0[0] + bf_lo(gb.x) * yb0[0], bf_hi(ga.x) * ya0[1] + bf_hi(gb.x) * yb0[1]);
                w.y = cvt_pk_bf16(bf_lo(ga.y) * ya0[2] + bf_lo(gb.y) * yb0[2], bf_hi(ga.y) * ya0[3] + bf_hi(gb.y) * yb0[3]);
                w.z = cvt_pk_bf16(bf_lo(ga.z) * ya1[0] + bf_lo(gb.z) * yb1[0], bf_hi(ga.z) * ya1[1] + bf_hi(gb.z) * yb1[1]);
                w.w = cvt_pk_bf16(bf_lo(ga.w) * ya1[2] + bf_lo(gb.w) * yb1[2], bf_hi(ga.w) * ya1[3] + bf_hi(gb.w) * yb1[3]);
                *(u32x4*)(MIX + row * 2048 + c0) = w;
            }
    }
};

template <bool WRITE_HG> struct EpiRes {
    static constexpr bool PERM = true, AFTER_DRAIN = false;
    const float* R; float* H; bf16_t* HG; const float* gvec; float* SS; PG8_LAS unsigned char* xch;
    __device__ __forceinline__ void operator()(const f32x4 (&acc)[2][2][4][2], const Unit& u, int wr, int wc, int fr, int fq) const {
        const int row0 = u.pm * BM + wr * 64 + fr, col0 = u.pn * BM + wc * 32 + 8 * fq;
        PG8_LAS float* X = (PG8_LAS float*)xch;
        f32x4 gv[2][2];
        if (WRITE_HG) {
#pragma unroll
            for (int bj = 0; bj < 2; ++bj)
#pragma unroll
                for (int n = 0; n < 2; ++n) gv[bj][n] = *(const f32x4*)(gvec + col0 + bj * HALF + 4 * n);
        }
#pragma unroll
        for (int ai = 0; ai < 2; ++ai)
#pragma unroll
            for (int m = 0; m < 4; ++m) {
                const int lrow = ai * HALF + wr * 64 + m * 16 + fr; const size_t off = (size_t)(row0 + ai * HALF + m * 16) * 2048 + col0;
                float ss = 0.f;
#pragma unroll
                for (int bj = 0; bj < 2; ++bj) {
                    const f32x4 r0 = *(const f32x4*)(R + off + bj * HALF), r1 = *(const f32x4*)(R + off + bj * HALF + 4);
                    const f32x4 h0 = r0 + acc[ai][bj][m][0], h1 = r1 + acc[ai][bj][m][1];
                    *(f32x4*)(H + off + bj * HALF) = h0; *(f32x4*)(H + off + bj * HALF + 4) = h1;
                    ss += (h0[0] * h0[0] + h0[1] * h0[1]) + (h0[2] * h0[2] + h0[3] * h0[3]) + (h1[0] * h1[0] + h1[1] * h1[1]) + (h1[2] * h1[2] + h1[3] * h1[3]);
                    if (WRITE_HG) { const f32x4 a0 = h0 * gv[bj][0], a1 = h1 * gv[bj][1]; u32x4 w; w.x = cvt_pk_bf16(a0[0], a0[1]); w.y = cvt_pk_bf16(a0[2], a0[3]); w.z = cvt_pk_bf16(a1[0], a1[1]); w.w = cvt_pk_bf16(a1[2], a1[3]);
                        *(u32x4*)(HG + off + bj * HALF) = w; }
                }
                ss += __shfl_xor(ss, 16); ss += __shfl_xor(ss, 32);
                if (fq == 0) X[lrow * 4 + wc] = ss;
            }
        EPI_BAR();
        const int tid = threadIdx.x;
        if (tid < 256) { const f32x4 p = *(const PG8_LAS f32x4*)(X + tid * 4); SS[(size_t)(u.pm * BM + tid) * 8 + u.pn] = (p[0] + p[1]) + (p[2] + p[3]); }
    }
};

struct EpiUp {
    static constexpr bool PERM = true, AFTER_DRAIN = false;
    bf16_t* ACT; const float* SS1; const float* convw; const float* convb; float* edgeA; float* edgePre; float* edgeB; PG8_LAS unsigned char* xch;
    __device__ __forceinline__ void operator()(const f32x4 (&acc)[2][2][4][2], const Unit& u, int wr, int wc, int fr, int fq) const {
        const int lane = fq * 16 + fr, cw = wc * 32 + 8 * fq, cbase = u.pn * HALF + cw;
        PG8_LAS float* top = (PG8_LAS float*)xch; PG8_LAS float* bot = top + 512;
        float rs[2][4];
#pragma unroll
        for (int ai = 0; ai < 2; ++ai)
#pragma unroll
            for (int m = 0; m < 4; ++m) { const size_t row = (size_t)(u.pm * BM + ai * HALF + wr * 64 + m * 16 + fr);
                const f32x4 s0 = *(const f32x4*)(SS1 + row * 8), s1 = *(const f32x4*)(SS1 + row * 8 + 4);
                rs[ai][m] = 1.0f / sqrtf(((s0[0] + s0[1]) + (s0[2] + s0[3]) + (s1[0] + s1[1]) + (s1[2] + s1[3])) * (1.0f / 2048.0f) + 1e-6f); }
#pragma unroll
        for (int ai = 0; ai < 2; ++ai) { const int gam = 2 * ai + wr; PG8_LAS float* dstp = (fr == 0 ? top : bot) + gam * 128 + cw; const float rsel = fr == 0 ? rs[ai][0] : rs[ai][3];
#pragma unroll
            for (int n = 0; n < 2; ++n) { f32x4 v;
#pragma unroll
                for (int j = 0; j < 4; ++j) v[j] = (fr == 0 ? acc[ai][0][0][n][j] : acc[ai][0][3][n][j]) * rsel;
                if (fr == 0 || fr == 15) *(PG8_LAS f32x4*)(dstp + 4 * n) = v; }
        }
        EPI_BAR();
        const int src_up = fr > 0 ? lane - 1 : lane + 15, src_dn = fr < 15 ? lane + 1 : lane - 15;
        u32x2 keep[2][4];
#pragma unroll
        for (int n = 0; n < 2; ++n) {
            const int c = cbase + 4 * n;
            const f32x4 w0 = *(const f32x4*)(convw + c), w1 = *(const f32x4*)(convw + 6144 + c), w2 = *(const f32x4*)(convw + 12288 + c), cb = *(const f32x4*)(convb + c);
#pragma unroll
            for (int ai = 0; ai < 2; ++ai) { const int gam = 2 * ai + wr;
                const f32x4 zero = {0.f, 0.f, 0.f, 0.f};
                const f32x4 hprev = gam > 0 ? *(const PG8_LAS f32x4*)(bot + (gam - 1) * 128 + cw + 4 * n) : zero;
                const f32x4 hnext = gam < 3 ? *(const PG8_LAS f32x4*)(top + (gam + 1) * 128 + cw + 4 * n) : zero;
                f32x4 am[4];
#pragma unroll
                for (int m = 0; m < 4; ++m) am[m] = acc[ai][0][m][n] * rs[ai][m];
#pragma unroll
                for (int m = 0; m < 4; ++m) {
                    const f32x4 cur = am[m];
                    const f32x4 prow = m > 0 ? am[m - 1] : hprev, nrow = m < 3 ? am[m + 1] : hnext;
                    const f32x4 y = fr == 15 ? prow : cur, z = fr == 0 ? nrow : cur;
                    f32x4 up = shfl4(y, src_up), dn = shfl4(z, src_dn);
                    if (m == 0 && fr == 0) up = hprev;
                    if (m == 3 && fr == 15) dn = hnext;
                    const f32x4 conv = w0 * up + w1 * cur + w2 * dn + cb;
                    const f32x4 bv = acc[ai][1][m][n] * rs[ai][m];
                    const f32x4 o = gelu4(conv) * bv;
                    u32x2 pk; pk.x = cvt_pk_bf16(o[0], o[1]); pk.y = cvt_pk_bf16(o[2], o[3]);
                    if (gam == 0 && m == 0 && fr == 0) { const size_t e = ((size_t)u.pm * 2 + 0) * 6144 + c; *(f32x4*)(edgeA + e) = cur; *(f32x4*)(edgePre + e) = conv; *(f32x4*)(edgeB + e) = bv; }
                    if (gam == 3 && m == 3 && fr == 15) { const size_t e = ((size_t)u.pm * 2 + 1) * 6144 + c; *(f32x4*)(edgeA + e) = cur; *(f32x4*)(edgePre + e) = conv; *(f32x4*)(edgeB + e) = bv; }
                    if (n == 0) keep[ai][m] = pk;
                    else { u32x4 w; w.x = keep[ai][m].x; w.y = keep[ai][m].y; w.z = pk.x; w.w = pk.y;
                        *(u32x4*)(ACT + (size_t)(u.pm * BM + ai * HALF + wr * 64 + m * 16 + fr) * 6144 + cbase) = w; }
                }
            }
        }
    }
};
template <class Epi, class Sched, bool ALIGN_EPI = false, bool SP2 = false>
__device__ __forceinline__ void gemm_phase(PG8_LAS unsigned char* lds, const Gemm g, const Sched& S, const Epi& E) {
    const int tid = threadIdx.x, wid = __builtin_amdgcn_readfirstlane(tid >> 6), lane = tid & 63, wr = wid >> 2, wc = wid & 3, fr = lane & 15, fq = lane >> 4;
    const int K = g.K, nt = K / BK;
    unsigned voffA[2], voffB[2];
#pragma unroll
    for (int i = 0; i < 2; ++i) { int R, C; stage_rc(tid * 16 + i * 8192, R, C); const int Rb = Epi::PERM ? ((R & ~31) + perm32(R & 31)) : R;
        voffA[i] = (unsigned)(R * K + C) * 2u; voffB[i] = (unsigned)(Rb * K + C) * 2u; }
    const size_t kstep = (size_t)(BK * 2);
    const size_t hstep = (size_t)HALF * K * 2;
    const size_t tstep = 2 * hstep;
    const unsigned ldsw = (unsigned)wid * 1024u;
    const int aoff = lds_byte(wr * 64 + fr, fq * 8), boff = lds_byte(wc * 32 + fr, fq * 8);
#define PG8_SA(b, h) (((b) * 2 + (h)) * HTB)
#define PG8_SB(b, h) ((4 + (b) * 2 + (h)) * HTB)
#define PG8_STAGE(bufoff, gbase, voff) do { _Pragma("unroll") for (int _i = 0; _i < 2; ++_i) \
        __builtin_amdgcn_global_load_lds((const unsigned*)((const char*)(gbase) + (voff)[_i]), (PG8_LAS unsigned*)(lds + (bufoff) + ldsw + _i * 8192), 16, 0, 0); } while (0)
#define PG8_LDA(dst, b, h) do { _Pragma("unroll") for (int m = 0; m < 4; ++m) _Pragma("unroll") for (int k = 0; k < 2; ++k) dst[m][k] = *(const PG8_LAS bf16x8*)(lds + PG8_SA(b, h) + aoff + m * 2048 + k * 1024); } while (0)
#define PG8_LDB(dst, b, h) do { _Pragma("unroll") for (int n = 0; n < 2; ++n) _Pragma("unroll") for (int k = 0; k < 2; ++k) dst[n][k] = *(const PG8_LAS bf16x8*)(lds + PG8_SB(b, h) + boff + n * 2048 + k * 1024); } while (0)
#define PG8_MMA(ai, bj, At, Bt) do { __builtin_amdgcn_s_setprio(1); _Pragma("unroll") for (int m = 0; m < 4; ++m) _Pragma("unroll") for (int n = 0; n < 2; ++n) _Pragma("unroll") for (int k = 0; k < 2; ++k) \
        acc[ai][bj][m][n] = __builtin_amdgcn_mfma_f32_16x16x32_bf16(Bt[n][k], At[m][k], acc[ai][bj][m][n], 0, 0, 0); __builtin_amdgcn_s_setprio(0); } while (0)
#define PG8_WAIT_V(n) asm volatile("s_waitcnt vmcnt(" #n ")" ::: "memory")
#define PG8_WAIT_L(n) asm volatile("s_waitcnt lgkmcnt(" #n ")" ::: "memory")
#define PG8_BAR __builtin_amdgcn_s_barrier()
#define PG8_SCHED __builtin_amdgcn_sched_barrier(0)
    Unit cur, nxt; int ui = 0;
    if (!S.next(0, cur)) return;
    f32x4 acc[2][2][4][2];
#pragma unroll
    for (int a = 0; a < 2; ++a)
#pragma unroll
        for (int b = 0; b < 2; ++b)
#pragma unroll
            for (int m = 0; m < 4; ++m)
#pragma unroll
                for (int n = 0; n < 2; ++n) acc[a][b][m][n] = (f32x4){0.f, 0.f, 0.f, 0.f};
    bf16x8 At[4][2], B0[2][2], B1[2][2];
    const char* cA = (const char*)g.A + (size_t)cur.pm * tstep; const char* cB = (const char*)g.Bt + (size_t)cur.pn * tstep;
    S.a_ready(cur);
    if constexpr (SP2) {
        PG8_STAGE(PG8_SB(0, 0), cB, voffB); PG8_STAGE(PG8_SB(0, 1), cB + hstep, voffB); PG8_STAGE(PG8_SA(0, 0), cA, voffA); PG8_STAGE(PG8_SA(0, 1), cA + hstep, voffA);
        if (wr == 1) PG8_BAR;
        PG8_WAIT_V(2); PG8_BAR;
        PG8_STAGE(PG8_SB(1, 0), cB + kstep, voffB); PG8_STAGE(PG8_SA(1, 0), cA + kstep, voffA); PG8_STAGE(PG8_SB(1, 1), cB + hstep + kstep, voffB);
        PG8_WAIT_V(6); PG8_BAR;
    } else {
        PG8_STAGE(PG8_SB(0, 0), cB, voffB); PG8_STAGE(PG8_SA(0, 0), cA, voffA); PG8_STAGE(PG8_SB(0, 1), cB + hstep, voffB); PG8_STAGE(PG8_SA(0, 1), cA + hstep, voffA);
        if (wr == 1) PG8_BAR;
        PG8_WAIT_V(4); PG8_BAR;
        PG8_STAGE(PG8_SB(1, 0), cB + kstep, voffB); PG8_STAGE(PG8_SA(1, 0), cA + kstep, voffA); PG8_STAGE(PG8_SB(1, 1), cB + hstep + kstep, voffB);
        PG8_WAIT_V(6); PG8_BAR;
    }
    for (;;) {
        const bool has_next = S.next(ui + 1, nxt);
        const char* nA = has_next ? (const char*)g.A + (size_t)nxt.pm * tstep : cA; const char* nB = has_next ? (const char*)g.Bt + (size_t)nxt.pn * tstep : cB;
        for (int t = 0; t < nt; t += 2) {
            const bool last = (t == nt - 2);
            const char* a1 = cA + (size_t)(t + 1) * kstep;
            const char* a2 = last ? nA : cA + (size_t)(t + 2) * kstep; const char* b2 = last ? nB : cB + (size_t)(t + 2) * kstep;
            const char* a3 = a2 + kstep; const char* b3 = b2 + kstep;
            if (last && has_next) S.a_ready(nxt);
            if constexpr (SP2) {
            PG8_LDB(B0, 0, 0); PG8_LDB(B1, 0, 1); PG8_SCHED; PG8_LDA(At, 0, 0); PG8_STAGE(PG8_SA(1, 1), a1 + hstep, voffA);
            PG8_WAIT_V(8); PG8_WAIT_L(0); PG8_BAR; PG8_MMA(0, 0, At, B0); PG8_MMA(0, 1, At, B1); PG8_BAR; PG8_SCHED;
            PG8_LDA(At, 0, 1); PG8_STAGE(PG8_SB(0, 0), b2, voffB); PG8_STAGE(PG8_SB(0, 1), b2 + hstep, voffB); PG8_STAGE(PG8_SA(0, 0), a2, voffA);
            PG8_WAIT_V(8); PG8_WAIT_L(0); PG8_BAR; PG8_MMA(1, 0, At, B0); PG8_MMA(1, 1, At, B1); PG8_BAR; PG8_SCHED;
            PG8_LDB(B0, 1, 0); PG8_LDB(B1, 1, 1); PG8_SCHED; PG8_LDA(At, 1, 0); PG8_STAGE(PG8_SA(0, 1), a2 + hstep, voffA);
            PG8_WAIT_V(8); PG8_WAIT_L(0); PG8_BAR; PG8_MMA(0, 0, At, B0); PG8_MMA(0, 1, At, B1); PG8_BAR; PG8_SCHED;
            PG8_LDA(At, 1, 1); PG8_STAGE(PG8_SB(1, 0), b3, voffB); PG8_STAGE(PG8_SB(1, 1), b3 + hstep, voffB); PG8_STAGE(PG8_SA(1, 0), a3, voffA);
            PG8_WAIT_V(8); PG8_WAIT_L(0); PG8_BAR; PG8_MMA(1, 0, At, B0); PG8_MMA(1, 1, At, B1); PG8_BAR; PG8_SCHED;
            } else {
            PG8_LDB(B0, 0, 0); PG8_SCHED; PG8_LDA(At, 0, 0); PG8_STAGE(PG8_SA(1, 1), a1 + hstep, voffA);
            PG8_WAIT_L(8); PG8_BAR; PG8_WAIT_L(0); PG8_MMA(0, 0, At, B0); PG8_BAR; PG8_SCHED;
            PG8_LDB(B1, 0, 1); PG8_STAGE(PG8_SB(0, 0), b2, voffB);
            PG8_BAR; PG8_WAIT_L(0); PG8_MMA(0, 1, At, B1); PG8_BAR;
            PG8_LDA(At, 0, 1); PG8_STAGE(PG8_SA(0, 0), a2, voffA);
            PG8_BAR; PG8_WAIT_L(0); PG8_MMA(1, 0, At, B0); PG8_BAR; PG8_SCHED;
            PG8_STAGE(PG8_SB(0, 1), b2 + hstep, voffB);
            PG8_WAIT_V(6); PG8_BAR; PG8_MMA(1, 1, At, B1); PG8_BAR;
            PG8_LDB(B0, 1, 0); PG8_SCHED; PG8_LDA(At, 1, 0); PG8_STAGE(PG8_SA(0, 1), a2 + hstep, voffA);
            PG8_WAIT_L(8); PG8_BAR; PG8_WAIT_L(0); PG8_MMA(0, 0, At, B0); PG8_BAR; PG8_SCHED;
            PG8_LDB(B1, 1, 1); PG8_STAGE(PG8_SB(1, 0), b3, voffB);
            PG8_BAR; PG8_WAIT_L(0); PG8_MMA(0, 1, At, B1); PG8_BAR;
            PG8_LDA(At, 1, 1); PG8_STAGE(PG8_SA(1, 0), a3, voffA);
            PG8_BAR; PG8_WAIT_L(0); PG8_MMA(1, 0, At, B0); PG8_BAR; PG8_SCHED;
            PG8_STAGE(PG8_SB(1, 1), b3 + hstep, voffB);
            PG8_WAIT_V(6); PG8_BAR; PG8_MMA(1, 1, At, B1); PG8_BAR;
            }
        }
        if constexpr (ALIGN_EPI) { if (wr == 0) PG8_BAR; }
        if constexpr (!Epi::AFTER_DRAIN) { E(acc, cur, wr, wc, fr, fq); S.done(cur); }
        if (!has_next) break;
#pragma unroll
        for (int a = 0; a < 2; ++a)
#pragma unroll
            for (int b = 0; b < 2; ++b)
#pragma unroll
                for (int m = 0; m < 4; ++m)
#pragma unroll
                    for (int n = 0; n < 2; ++n) acc[a][b][m][n] = (f32x4){0.f, 0.f, 0.f, 0.f};
        cur = nxt; cA = nA; cB = nB; ++ui;
        if constexpr (ALIGN_EPI) { if (wr == 1) PG8_BAR; }
    }
    PG8_WAIT_V(0);
    if constexpr (!ALIGN_EPI) { if (wr == 0) PG8_BAR; }
    PG8_BAR;
    if constexpr (Epi::AFTER_DRAIN) { E.fused(acc, cur, wr, wc, fr, fq, lds, wid, lane); S.done(cur); }
#undef PG8_SA
#undef PG8_SB
#undef PG8_STAGE
#undef PG8_LDA
#undef PG8_LDB
#undef PG8_MMA
#undef PG8_WAIT_V
#undef PG8_WAIT_L
#undef PG8_BAR
#undef PG8_SCHED
}
}
#ifndef MK_N_LAUNCHES
#define MK_N_LAUNCHES 1
#endif
#define LAS __attribute__((address_space(3)))
typedef unsigned short bf16_t;
typedef unsigned v4u __attribute__((ext_vector_type(4)));
typedef unsigned v2u __attribute__((ext_vector_type(2)));
typedef float f32x4 __attribute__((ext_vector_type(4)));
typedef float f32x16 __attribute__((ext_vector_type(16)));
typedef short bf16x8 __attribute__((ext_vector_type(8)));
typedef short s16x4 __attribute__((ext_vector_type(4)));
constexpr int SEQ = 4096, DM = 2048, TOK = 4 * SEQ, DFF = 6144;
constexpr size_t MiB = 1u << 20;
constexpr size_t WS_ROPE = 0, WS_SS1 = 1 * MiB, WS_SS2 = 1 * MiB + 512 * 1024, WS_LSE = 2 * MiB, WS_EDGE = 3 * MiB  ,
                 WS_W1 = 12 * MiB, WS_W2 = 48 * MiB, WS_W3 = 56 * MiB, WS_W4 = 64 * MiB, WS_W5 = 112 * MiB,
                 WS_QKV = 136 * MiB, WS_P = 280 * MiB, WS_A2 = 296 * MiB, WS_G = 328 * MiB, WS_END = 456 * MiB;
constexpr size_t WS_MIX = WS_QKV  , WS_ACT = WS_QKV  , WS_HG = WS_G  ;
constexpr size_t EDGE_ELEMS = 64 * 2 * 6144;
constexpr size_t OUT_U = 0, OUT_OG = 64 * MiB;
constexpr int RING_BYTES = 131072, XCH_OFF = RING_BYTES, LDS_BYTES = RING_BYTES + 16384;
constexpr int NPH = 10;

__device__ __forceinline__ float wave_sum(float v) {
#pragma unroll
    for (int o = 1; o < 64; o <<= 1) v += __shfl_xor(v, o);
    return v;
}
__device__ __forceinline__ unsigned pk2(float lo, float hi) { return pg8::cvt_pk_bf16(lo, hi); }
__device__ __forceinline__ float bflo(unsigned w) { return __uint_as_float(w << 16); }
__device__ __forceinline__ float bfhi(unsigned w) { return __uint_as_float(w & 0xffff0000u); }

__device__ __forceinline__ void tr_item(const float* __restrict__ W, int N, int k0, int n0, bf16_t* dst, int ldt, LAS float* scr, int lane) {
#pragma unroll 8
    for (int i = 0; i < 32; ++i) { const int kk = 2 * i + (lane >> 5); scr[kk * 33 + (lane & 31)] = W[(size_t)(k0 + kk) * N + n0 + (lane & 31)]; }
    asm volatile("s_waitcnt lgkmcnt(0)" ::: "memory");
    const int c = lane & 7;
#pragma unroll
    for (int j = 0; j < 4; ++j) { const int n = (lane >> 3) + 8 * j; const LAS float* s = scr + (8 * c) * 33 + n;
        v4u o; o.x = pk2(s[0 * 33], s[1 * 33]); o.y = pk2(s[2 * 33], s[3 * 33]); o.z = pk2(s[4 * 33], s[5 * 33]); o.w = pk2(s[6 * 33], s[7 * 33]);
        *(v4u*)(dst + (size_t)n * ldt + 8 * c) = o; }
    asm volatile("s_waitcnt lgkmcnt(0)" ::: "memory");
}
__device__ __forceinline__ void sincos_d(double x, double& s, double& c) {
    const double x2 = x * x; double ts = 1.0, tc = 1.0, ss = 1.0, cc = 1.0;
#pragma unroll
    for (int k = 1; k <= 14; ++k) { tc *= -x2 / (double)((2 * k - 1) * (2 * k)); ts *= -x2 / (double)((2 * k) * (2 * k + 1)); cc += tc; ss += ts; }
    s = x * ss; c = cc;
}

__device__ __forceinline__ unsigned off_b(unsigned row, unsigned ch) { return 256u * row + 16u * (ch ^ (((row & 3) << 2) | ((row >> 2) & 3))); }
__device__ __forceinline__ unsigned tr_addr(unsigned lane, unsigned c, unsigned ks, unsigned t) {
    const unsigned h = lane >> 5, blk = (lane >> 4) & 1, q = (lane & 15) >> 2, p = lane & 3;
    return off_b(16 * ks + 8 * h + 4 * t + q, 4 * c + 2 * blk + (p >> 1)) + 8 * (p & 1);
}
typedef short v4i16_t __attribute__((ext_vector_type(4)));
__device__ __forceinline__ s16x4 vtr(LAS const unsigned char* p) { return __builtin_bit_cast(s16x4, __builtin_amdgcn_ds_read_tr16_b64_v4i16((LAS v4i16_t*)p)); }

__device__ __forceinline__ void attn_unit(int uid, const bf16_t* __restrict__ QKV, bf16_t* __restrict__ OG, float* __restrict__ LSE, LAS unsigned char* lds) {
    const int tid = threadIdx.x, lane = tid & 63, w = __builtin_amdgcn_readfirstlane(tid >> 6), ql = lane & 31, hi = lane >> 5;
    const int b = uid / 192, rem = uid % 192, h = rem >> 4, sub = rem & 15;
    const int g = h >> 2, slot = h & 3, dsh = 2 * g, L = SEQ >> dsh, cpr = 16 >> dsh;
    const int res = sub / cpr, chunk = sub % cpr, l0 = 256 * chunk;
    const size_t rowb = (size_t)b * SEQ;
    const bf16_t* Qb = QKV + h * 128; const bf16_t* Kb = QKV + 1536 + h * 128; const bf16_t* Vb = QKV + 3072 + h * 128;
    v4u vreg[12];
#pragma unroll
    for (int i = 0; i < 12; ++i) {
        const int n = tid + 512 * i, om = n >> 4, ch = n & 15; int lk = l0 - 64 + om; lk = lk < 0 ? 0 : (lk > L - 1 ? L - 1 : lk);
        const size_t ro = (rowb + (size_t)((lk << dsh) + res)) * 4608 + ch * 8;
        const v4u kv = *(const v4u*)(Kb + ro);
        vreg[i] = *(const v4u*)(Vb + ro);
        *(LAS v4u*)(lds + (om >> 5) * 8192 + off_b(om & 31, ch)) = kv;
    }
    bf16x8 qf[8];
    { const int lq = l0 + 32 * w + ql; const bf16_t* qp = Qb + (rowb + (size_t)((lq << dsh) + res)) * 4608 + 8 * hi;
#pragma unroll
      for (int s = 0; s < 8; ++s) qf[s] = *(const bf16x8*)(qp + 16 * s); }
    __syncthreads();
    f32x16 S[5];
#pragma unroll
    for (int j = 0; j < 5; ++j) {
        S[j] = (f32x16){0.f, 0.f, 0.f, 0.f, 0.f, 0.f, 0.f, 0.f, 0.f, 0.f, 0.f, 0.f, 0.f, 0.f, 0.f, 0.f};
#pragma unroll
        for (int s = 0; s < 8; ++s) { const bf16x8 kf = *(const LAS bf16x8*)(lds + (w + j) * 8192 + off_b(ql, 2 * s + hi)); S[j] = __builtin_amdgcn_mfma_f32_32x32x16_bf16(kf, qf[s], S[j], 0, 0, 0); }
    }
    float mx = -INFINITY;
#pragma unroll
    for (int j = 0; j < 5; ++j)
#pragma unroll
        for (int r = 0; r < 16; ++r) { const int kap = (r & 3) + 8 * (r >> 2) + 4 * hi; const int lk = l0 - 64 + 32 * (w + j) + kap;
            bool ok = (lk >= 0) && (lk < L); if (j == 0) ok = ok && (kap >= ql); if (j == 4) ok = ok && (kap <= ql);
            const float v = ok ? S[j][r] : -INFINITY; S[j][r] = v; mx = fmaxf(mx, v); }
    mx = fmaxf(mx, __shfl_xor(mx, 32));
    float den = 0.f;
#pragma unroll
    for (int j = 0; j < 5; ++j)
#pragma unroll
        for (int r = 0; r < 16; ++r) { const float p = __builtin_amdgcn_exp2f(S[j][r] - mx); S[j][r] = p; den += p; }
    den += __shfl_xor(den, 32);
    bf16x8 pk[5][2];
#pragma unroll
    for (int j = 0; j < 5; ++j)
#pragma unroll
        for (int ks = 0; ks < 2; ++ks) { v4u t4; t4.x = pk2(S[j][8 * ks + 0], S[j][8 * ks + 1]); t4.y = pk2(S[j][8 * ks + 2], S[j][8 * ks + 3]); t4.z = pk2(S[j][8 * ks + 4], S[j][8 * ks + 5]); t4.w = pk2(S[j][8 * ks + 6], S[j][8 * ks + 7]);
            pk[j][ks] = __builtin_bit_cast(bf16x8, t4); }
    __syncthreads();
#pragma unroll
    for (int i = 0; i < 12; ++i) { const int n = tid + 512 * i, om = n >> 4, ch = n & 15, rho = om & 31, rho2 = (rho & 19) | ((rho & 4) << 1) | ((rho & 8) >> 1);
        *(LAS v4u*)(lds + (om >> 5) * 8192 + off_b(rho2, ch)) = vreg[i]; }
    __syncthreads();
    f32x16 o[4];
#pragma unroll
    for (int c = 0; c < 4; ++c) o[c] = (f32x16){0.f, 0.f, 0.f, 0.f, 0.f, 0.f, 0.f, 0.f, 0.f, 0.f, 0.f, 0.f, 0.f, 0.f, 0.f, 0.f};
#pragma unroll
    for (int j = 0; j < 5; ++j)
#pragma unroll
        for (int ks = 0; ks < 2; ++ks)
#pragma unroll
            for (int c = 0; c < 4; ++c) {
                const s16x4 lo = vtr(lds + (w + j) * 8192 + tr_addr(lane, c, ks, 0)), hi4 = vtr(lds + (w + j) * 8192 + tr_addr(lane, c, ks, 1));
                const bf16x8 vf = {lo[0], lo[1], lo[2], lo[3], hi4[0], hi4[1], hi4[2], hi4[3]};
                o[c] = __builtin_amdgcn_mfma_f32_32x32x16_bf16(vf, pk[j][ks], o[c], 0, 0, 0);
            }
    const float inv = 1.0f / den;
    const int lq = l0 + 32 * w + ql; const size_t row = rowb + (size_t)((lq << dsh) + res);
    bf16_t* op = OG + ((size_t)g * TOK + row) * 512 + slot * 128 + 4 * hi;
#pragma unroll
    for (int c = 0; c < 4; ++c)
#pragma unroll
        for (int rq = 0; rq < 4; ++rq) { v2u t2; t2.x = pk2(o[c][4 * rq] * inv, o[c][4 * rq + 1] * inv); t2.y = pk2(o[c][4 * rq + 2] * inv, o[c][4 * rq + 3] * inv); *(v2u*)(op + 32 * c + 8 * rq) = t2; }
    if (hi == 0) LSE[((size_t)g * TOK + row) * 4 + slot] = (mx + __builtin_amdgcn_logf(den)) * 0.6931471805599453f;
    __syncthreads();
}

struct Args { const float* in[15]; float* out; unsigned char* ws; int ph_lo, ph_hi; };
typedef const __attribute__((address_space(4))) Args* KArgs;
__device__ __forceinline__ KArgs kargs() { KArgs p = (KArgs)__builtin_amdgcn_kernarg_segment_ptr(); asm volatile("" : "+s"(p)); return p; }
#define KA_IN(i) ((const float*)ka->in[i])
#define KA_WS(off) ((unsigned char*)ka->ws + (off))

__global__ void __launch_bounds__(512, 2) mega_fwd(Args a) {
    extern __shared__ __attribute__((aligned(16))) unsigned char lds_raw[];
    LAS unsigned char* lds = (LAS unsigned char*)lds_raw;
    cg::grid_group grid = cg::this_grid();
    const int tid = threadIdx.x, lane = tid & 63, wave = __builtin_amdgcn_readfirstlane(tid >> 6);
    const int G = gridDim.x, gw = blockIdx.x * 8 + wave, NGW = G * 8, gtid = blockIdx.x * 512 + tid, NTH = G * 512;
    const int lo = a.ph_lo, hi_ph = a.ph_hi;
#ifndef MK_PHASE_MASK
#define MK_PHASE_MASK 0x3ff
#endif
#define IN(k) (((MK_PHASE_MASK >> (k)) & 1) && lo <= (k) && (k) < hi_ph)
#define SEAM(k) do { if (IN(k) && IN((k) + 1)) grid.sync(); } while (0)

    if (IN(0)) {
        KArgs ka = kargs();
        const float* x = KA_IN(0); const float* g_mix = KA_IN(1); const float* w_in = KA_IN(2); const float* w_ao = KA_IN(3); const float* pool_w = KA_IN(4); const float* pool_s = KA_IN(5);
        const float* w_po = KA_IN(6); const float* w_gate = KA_IN(7); const float* w_out = KA_IN(8); const float* w_up = KA_IN(10); const float* w_down = KA_IN(13);
        bf16_t* W1t = (bf16_t*)KA_WS(WS_W1); bf16_t* W2t = (bf16_t*)KA_WS(WS_W2); bf16_t* W3t = (bf16_t*)KA_WS(WS_W3); bf16_t* W4t = (bf16_t*)KA_WS(WS_W4); bf16_t* W5t = (bf16_t*)KA_WS(WS_W5);
        float* rope = (float*)KA_WS(WS_ROPE); bf16_t* U = (bf16_t*)((unsigned char*)ka->out + OUT_U);
        LAS float* scr = (LAS float*)(lds + wave * 16384);
        constexpr int I_IN = 32 * 160, I_GATE = 32 * 128, I_AO = 8 * 64, I_OUT = 32 * 64, I_UP = 32 * 384, I_DOWN = 96 * 64, NITEMS = I_IN + I_GATE + I_AO + I_OUT + I_UP + I_DOWN;
        for (int it = gw; it < NITEMS; it += NGW) {
            int r = it; const float* W; int N, ldt, mode; bf16_t* D;
            if (r < I_IN) { W = w_in; N = 5120; D = W1t; ldt = 2048; mode = 0; }
            else if ((r -= I_IN) < I_GATE) { W = w_gate; N = 4096; D = W1t + (size_t)5120 * 2048; ldt = 2048; mode = 0; }
            else if ((r -= I_GATE) < I_AO) { W = w_ao; N = 2048; D = W2t; ldt = 1024; mode = 1; }
            else if ((r -= I_AO) < I_OUT) { W = w_out; N = 2048; D = W3t; ldt = 2048; mode = 0; }
            else if ((r -= I_OUT) < I_UP) { W = w_up; N = 12288; D = W4t; ldt = 2048; mode = 2; }
            else { r -= I_UP; W = w_down; N = 2048; D = W5t; ldt = 6144; mode = 0; }
            const int nblk = N >> 5, kb = r / nblk, nb = r - kb * nblk, k0 = 64 * kb, n0 = 32 * nb;
            int drow = n0;
            if (mode == 1) drow = 256 * (n0 >> 7) + (n0 & 127);
            if (mode == 2) { const int c = n0 < 6144 ? n0 : n0 - 6144; drow = 256 * (c >> 7) + (n0 < 6144 ? 0 : 128) + (c & 127); }
            tr_item(W, N, k0, n0, D + (size_t)drow * ldt + k0, ldt, scr, lane);
        }
        for (int i = gtid; i < 4096 * 64; i += NTH) { const int row = i >> 6, ch = i & 63; *(v4u*)(W2t + (size_t)row * 1024 + ((row & 128) ? 0 : 512) + ch * 8) = (v4u){0u, 0u, 0u, 0u}; }
        for (int i = gtid; i < 2048 * 64; i += NTH) {
            const int n = i & 2047, cb = i >> 11, g = cb >> 4, cin0 = cb * 8;
            float accw[8];
#pragma unroll
            for (int e = 0; e < 8; ++e) accw[e] = 0.f;
            for (int d = 0; d < 128; ++d) { const float wv = pool_s[g * 128 + d] * w_po[(size_t)(g * 128 + d) * 2048 + n];
#pragma unroll
                for (int e = 0; e < 8; ++e) accw[e] += pool_w[(size_t)(cin0 + e) * 128 + d] * wv; }
            v4u o; o.x = pk2(accw[0], accw[1]); o.y = pk2(accw[2], accw[3]); o.z = pk2(accw[4], accw[5]); o.w = pk2(accw[6], accw[7]);
            *(v4u*)(W2t + (size_t)(256 * (n >> 7) + 128 + (n & 127)) * 1024 + 512 + cin0) = o;
        }
        for (int i = gtid; i < SEQ * 16; i += NTH) {
            const int pos = i >> 4, k = i & 15;
            const float invf = (float)exp2(-(double)k * (18.931568569324174 / 16.0));
            const float ang = (float)pos * invf;
            const double t = (double)ang * 0.15915494309189535; const double fr = t - rint(t);
            double s, c; sincos_d(fr * 6.283185307179586, s, c);
            rope[pos * 32 + k] = (float)c; rope[pos * 32 + 16 + k] = (float)s;
        }
        for (int m = gw; m < TOK; m += NGW) {
            const f32x4* xr = (const f32x4*)(x + (size_t)m * DM) + lane; f32x4 v[8]; float s = 0.f;
#pragma unroll
            for (int j = 0; j < 8; ++j) { v[j] = xr[64 * j]; s += (v[j][0] * v[j][0] + v[j][1] * v[j][1]) + (v[j][2] * v[j][2] + v[j][3] * v[j][3]); }
            const float rstd = 1.0f / sqrtf(wave_sum(s) * (1.0f / DM) + 1e-6f);
            v2u* o8 = (v2u*)(U + (size_t)m * DM) + lane;
#pragma unroll
            for (int j = 0; j < 8; ++j) { const f32x4 gg = *((const f32x4*)g_mix + lane + 64 * j); v2u t2; t2.x = pk2(v[j][0] * rstd * gg[0], v[j][1] * rstd * gg[1]); t2.y = pk2(v[j][2] * rstd * gg[2], v[j][3] * rstd * gg[3]); o8[64 * j] = t2; }
        }
    }
    SEAM(0);
    if (IN(1)) {
        KArgs ka = kargs();
        bf16_t* U = (bf16_t*)((unsigned char*)ka->out + OUT_U); bf16_t* W1t = (bf16_t*)KA_WS(WS_W1); bf16_t* QKV = (bf16_t*)KA_WS(WS_QKV); bf16_t* Pb = (bf16_t*)KA_WS(WS_P); bf16_t* Gb = (bf16_t*)KA_WS(WS_G); float* rope = (float*)KA_WS(WS_ROPE);
        pg8::Gemm g{U, W1t, TOK, 9216, 2048}; pg8::StaticOrder S; S.init(TOK, 9216, G, (int)blockIdx.x);
        pg8::EpiProj E{QKV, Pb, Gb, rope, 0.08838834764831845f * 1.4426950408889634f};
        pg8::gemm_phase<pg8::EpiProj, pg8::StaticOrder, true, true>(lds, g, S, E);
    }
    SEAM(1);
    if (IN(2)) {
        KArgs ka = kargs();
        bf16_t* QKV = (bf16_t*)KA_WS(WS_QKV); bf16_t* Pb = (bf16_t*)KA_WS(WS_P); bf16_t* A2 = (bf16_t*)KA_WS(WS_A2); float* LSE = (float*)KA_WS(WS_LSE); bf16_t* OG = (bf16_t*)((unsigned char*)ka->out + OUT_OG);
        for (int uid = blockIdx.x; uid < 768; uid += G) attn_unit(uid, QKV, OG, LSE, lds);
        for (int i = gtid; i < TOK * 64; i += NTH) {
            const int t = i >> 6, ch = i & 63, gp = ch >> 4, hw = 1 << gp  , tt = t & (SEQ - 1), tb = t - tt;
            const int plo = tt - hw < 0 ? 0 : tt - hw, phi = tt + hw > SEQ ? SEQ : tt + hw;
            float s[8];
#pragma unroll
            for (int e = 0; e < 8; ++e) s[e] = 0.f;
            for (int r = plo; r < phi; ++r) { const v4u v = *(const v4u*)(Pb + (size_t)(tb + r) * 512 + ch * 8);
                s[0] += bflo(v.x); s[1] += bfhi(v.x); s[2] += bflo(v.y); s[3] += bfhi(v.y); s[4] += bflo(v.z); s[5] += bfhi(v.z); s[6] += bflo(v.w); s[7] += bfhi(v.w); }
            const v4u me = *(const v4u*)(Pb + (size_t)t * 512 + ch * 8); const float ic = 1.0f / (float)(phi - plo);
            v4u o; o.x = pk2(s[0] * ic - bflo(me.x), s[1] * ic - bfhi(me.x)); o.y = pk2(s[2] * ic - bflo(me.y), s[3] * ic - bfhi(me.y));
            o.z = pk2(s[4] * ic - bflo(me.z), s[5] * ic - bfhi(me.z)); o.w = pk2(s[6] * ic - bflo(me.w), s[7] * ic - bfhi(me.w));
            *(v4u*)(A2 + (size_t)t * 1024 + 512 + ch * 8) = o;
        }
    }
    SEAM(2);
    if (IN(3)) {
        KArgs ka = kargs();
        bf16_t* A2 = (bf16_t*)KA_WS(WS_A2); float* LSE = (float*)KA_WS(WS_LSE); bf16_t* OG = (bf16_t*)((unsigned char*)ka->out + OUT_OG);
        for (int i = gtid; i < TOK * 64; i += NTH) {
            const int t = i >> 6, ch = i & 63, slot = ch >> 4;
            const float l0 = LSE[(size_t)t * 4 + slot], l1 = LSE[((size_t)TOK + t) * 4 + slot], l2 = LSE[((size_t)2 * TOK + t) * 4 + slot];
            const float m = fmaxf(l0, fmaxf(l1, l2)); const float e0 = __expf(l0 - m), e1 = __expf(l1 - m), e2 = __expf(l2 - m); const float is = 1.0f / (e0 + e1 + e2);
            const float a0 = e0 * is, a1 = e1 * is, a2 = e2 * is;
            const v4u v0 = *(const v4u*)(OG + (size_t)t * 512 + ch * 8), v1 = *(const v4u*)(OG + ((size_t)TOK + t) * 512 + ch * 8), v2 = *(const v4u*)(OG + ((size_t)2 * TOK + t) * 512 + ch * 8);
            v4u o;
            o.x = pk2(a0 * bflo(v0.x) + a1 * bflo(v1.x) + a2 * bflo(v2.x), a0 * bfhi(v0.x) + a1 * bfhi(v1.x) + a2 * bfhi(v2.x));
            o.y = pk2(a0 * bflo(v0.y) + a1 * bflo(v1.y) + a2 * bflo(v2.y), a0 * bfhi(v0.y) + a1 * bfhi(v1.y) + a2 * bfhi(v2.y));
            o.z = pk2(a0 * bflo(v0.z) + a1 * bflo(v1.z) + a2 * bflo(v2.z), a0 * bfhi(v0.z) + a1 * bfhi(v1.z) + a2 * bfhi(v2.z));
            o.w = pk2(a0 * bflo(v0.w) + a1 * bflo(v1.w) + a2 * bflo(v2.w), a0 * bfhi(v0.w) + a1 * bfhi(v1.w) + a2 * bfhi(v2.w));
            *(v4u*)(A2 + (size_t)t * 1024 + ch * 8) = o;
        }
    }
    SEAM(3);
    if (IN(4)) {
        KArgs ka = kargs();
        bf16_t* A2 = (bf16_t*)KA_WS(WS_A2); bf16_t* W2t = (bf16_t*)KA_WS(WS_W2); bf16_t* Gb = (bf16_t*)KA_WS(WS_G); bf16_t* MIX = (bf16_t*)KA_WS(WS_MIX);
        pg8::Gemm g{A2, W2t, TOK, 4096, 1024}; pg8::StaticOrder S; S.init(TOK, 4096, G, (int)blockIdx.x);
        pg8::EpiMix E{Gb, MIX};
        pg8::gemm_phase<pg8::EpiMix, pg8::StaticOrder, true, true>(lds, g, S, E);
    }
    SEAM(4);
    if (IN(5)) {
        KArgs ka = kargs();
        const float* x = KA_IN(0); const float* g_ffn = KA_IN(9); float* out = (float*)ka->out; bf16_t* MIX = (bf16_t*)KA_WS(WS_MIX); bf16_t* W3t = (bf16_t*)KA_WS(WS_W3); bf16_t* HG = (bf16_t*)KA_WS(WS_HG); float* SS1 = (float*)KA_WS(WS_SS1);
        pg8::Gemm g{MIX, W3t, TOK, 2048, 2048}; pg8::StaticOrder S; S.init(TOK, 2048, G, (int)blockIdx.x);
        pg8::EpiRes<true> E{x, out, HG, g_ffn, SS1, lds + XCH_OFF};
        pg8::gemm_phase<pg8::EpiRes<true>, pg8::StaticOrder, true, true>(lds, g, S, E);
    }
    SEAM(5);
    if (IN(6)) {
        KArgs ka = kargs();
        const float* conv_w = KA_IN(11); const float* conv_b = KA_IN(12); bf16_t* HG = (bf16_t*)KA_WS(WS_HG); bf16_t* W4t = (bf16_t*)KA_WS(WS_W4); bf16_t* ACT = (bf16_t*)KA_WS(WS_ACT); float* SS1 = (float*)KA_WS(WS_SS1);
        float* edgeA = (float*)KA_WS(WS_EDGE); float* edgePre = edgeA + EDGE_ELEMS; float* edgeB = edgePre + EDGE_ELEMS;
        pg8::Gemm g{HG, W4t, TOK, 12288, 2048}; pg8::StaticOrder S; S.init(TOK, 12288, G, (int)blockIdx.x);
        pg8::EpiUp E{ACT, SS1, conv_w, conv_b, edgeA, edgePre, edgeB, lds + XCH_OFF};
        pg8::gemm_phase<pg8::EpiUp, pg8::StaticOrder, true, true>(lds, g, S, E);
    }
    SEAM(6);
    if (IN(7)) {
        KArgs ka = kargs();
        const float* conv_w = KA_IN(11); bf16_t* ACT = (bf16_t*)KA_WS(WS_ACT);
        float* edgeA = (float*)KA_WS(WS_EDGE); float* edgePre = edgeA + EDGE_ELEMS; float* edgeB = edgePre + EDGE_ELEMS;
        for (int i = gtid; i < 128 * 1536; i += NTH) {
            const int c = 4 * (i % 1536), pe = i / 1536, pm = pe >> 1, e = pe & 1, row = pm * 256 + (e ? 255 : 0), tt = row & (SEQ - 1);
            if ((e == 0 && tt == 0) || (e == 1 && tt == SEQ - 1)) continue;
            const f32x4 pre = *(const f32x4*)(edgePre + (size_t)pe * 6144 + c), bb = *(const f32x4*)(edgeB + (size_t)pe * 6144 + c);
            const f32x4 nb = e == 0 ? *(const f32x4*)(edgeA + (size_t)(pe - 1) * 6144 + c) : *(const f32x4*)(edgeA + (size_t)(pe + 1) * 6144 + c);
            const f32x4 wv = *(const f32x4*)(conv_w + (e == 0 ? 0 : 12288) + c);
            const f32x4 o = pg8::gelu4(pre + wv * nb) * bb;
            v2u t2; t2.x = pk2(o[0], o[1]); t2.y = pk2(o[2], o[3]);
            *(v2u*)(ACT + (size_t)row * 6144 + c) = t2;
        }
    }
    SEAM(7);
    if (IN(8)) {
        KArgs ka = kargs();
        float* out = (float*)ka->out; bf16_t* ACT = (bf16_t*)KA_WS(WS_ACT); bf16_t* W5t = (bf16_t*)KA_WS(WS_W5); float* SS2 = (float*)KA_WS(WS_SS2);
        pg8::Gemm g{ACT, W5t, TOK, 2048, 6144}; pg8::StaticOrder S; S.init(TOK, 2048, G, (int)blockIdx.x);
        pg8::EpiRes<false> E{out, out, nullptr, nullptr, SS2, lds + XCH_OFF};
        pg8::gemm_phase<pg8::EpiRes<false>, pg8::StaticOrder, true, true>(lds, g, S, E);
    }
    SEAM(8);
    if (IN(9)) {
        KArgs ka = kargs();
        const float* g_fin = KA_IN(14); float* out = (float*)ka->out; float* SS2 = (float*)KA_WS(WS_SS2);
        for (int m = gw; m < TOK; m += NGW) {
            const f32x4 s0 = *(const f32x4*)(SS2 + (size_t)m * 8), s1 = *(const f32x4*)(SS2 + (size_t)m * 8 + 4);
            const float rstd = 1.0f / sqrtf(((s0[0] + s0[1]) + (s0[2] + s0[3]) + (s1[0] + s1[1]) + (s1[2] + s1[3])) * (1.0f / DM) + 1e-6f);
            f32x4* orow = (f32x4*)(out + (size_t)m * DM) + lane;
#pragma unroll
            for (int j = 0; j < 8; ++j) { const f32x4 gg = *((const f32x4*)g_fin + lane + 64 * j); f32x4 v = orow[64 * j]; v = v * rstd * gg; orow[64 * j] = v; }
        }
    }
#undef IN
#undef SEAM
}

extern "C" void kernel_launch(void* const* d_in, const int* in_sizes, int n_in, void* d_out, int out_size, void* d_ws, size_t ws_size, hipStream_t stream) {
    static int grid = 0;
    if (grid == 0) {
        if (n_in != 15 || out_size != TOK * DM || ws_size < WS_END) { fprintf(stderr, "kernel_launch: unexpected shapes (n_in %d, out %d, ws %zu)\n", n_in, out_size, ws_size); grid = -1; return; }
        int dev = 0, cus = 0, per_cu = 0;
        (void)hipGetDevice(&dev); (void)hipDeviceGetAttribute(&cus, hipDeviceAttributeMultiprocessorCount, dev);
        if (hipFuncSetAttribute((const void*)mega_fwd, hipFuncAttributeMaxDynamicSharedMemorySize, LDS_BYTES) != hipSuccess) { fprintf(stderr, "kernel_launch: hipFuncSetAttribute failed\n"); }
        if (hipOccupancyMaxActiveBlocksPerMultiprocessor(&per_cu, (const void*)mega_fwd, 512, LDS_BYTES) != hipSuccess || per_cu < 1) { fprintf(stderr, "kernel_launch: occupancy query gave %d\n", per_cu); per_cu = 1; }
        (void)hipGetLastError();
        grid = cus * 1;
        if (grid <= 0) grid = 256;
    }
    if (grid < 0) return;
    Args a{};
    for (int i = 0; i < 15; ++i) a.in[i] = (const float*)d_in[i];
    a.out = (float*)d_out; a.ws = (unsigned char*)d_ws;
#if MK_N_LAUNCHES == 1
    a.ph_lo = 0; a.ph_hi = NPH;
    void* args[] = {&a};
    hipError_t e = hipLaunchCooperativeKernel((const void*)mega_fwd, dim3(grid), dim3(512), args, LDS_BYTES, stream);
    if (e != hipSuccess) fprintf(stderr, "cooperative launch failed: %s (grid %d)\n", hipGetErrorString(e), grid);
#else
    for (int p = 0; p < NPH; ++p) { a.ph_lo = p; a.ph_hi = p + 1; hipLaunchKernelGGL(mega_fwd, dim3(grid), dim3(512), LDS_BYTES, stream, a); }
#endif
}
```
